# Optimizing an MI355X kernel written in HIP

```python
import math
import jax, jax.numpy as jnp
from jax import lax
import numpy as np

D_MODEL = 2048
BATCH = 1
SEQ = 8192
DEPTH = 1

BLK = 128
WINDOW = 128
HA = 16
KV_A = 2
G_A = HA // KV_A
DH_A = 64
HB = 8
DH_B = 64
N_BUCKETS = 32
MAX_DISTANCE = 128
H_BIAS = HA + HB
MEM_LEN = 256
HC = 4
DH_C = 128
D_FF = ((8 * D_MODEL // 3 + 255) // 256) * 256
QA_W = HA * DH_A
KVA_W = KV_A * DH_A
QB_W = HB * 2 * DH_B
VB_W = HB * 2 * DH_B
SPLITS = [QA_W, KVA_W, KVA_W, QB_W, QB_W, VB_W, D_MODEL, D_MODEL]
IN_WIDTH = sum(SPLITS)
SPLIT_IDX = [int(v) for v in np.cumsum(SPLITS)[:-1]]
LN_EPS = 1e-5

kernel_name = "hybrid_swa_sink_diffattn_deepnorm_layer"


def rel_bucket(dist):
    n = jnp.maximum(dist, 0)
    exact = N_BUCKETS // 2
    logv = jnp.log(jnp.maximum(n, 1).astype(jnp.float32) / exact) / math.log(MAX_DISTANCE / exact)
    large = exact + (logv * (N_BUCKETS - exact)).astype(jnp.int32)
    large = jnp.minimum(large, N_BUCKETS - 1)
    return jnp.where(n < exact, n, large)


def layer_norm(x, g, b):
    xf = x.astype(jnp.float32)
    mu = xf.mean(-1, keepdims=True)
    var = jnp.square(xf - mu).mean(-1, keepdims=True)
    y = (xf - mu) * lax.rsqrt(var + LN_EPS) * g.astype(jnp.float32) + b.astype(jnp.float32)
    return y.astype(x.dtype)


def swa_sink_attention(q, k, v, sinks, table):
    b, s = q.shape[0], q.shape[1]
    nb = s // BLK
    qb = q.reshape(b, nb, BLK, KV_A, G_A, DH_A)
    kb = k.reshape(b, nb, BLK, KV_A, DH_A)
    vb = v.reshape(b, nb, BLK, KV_A, DH_A)
    pad = ((0, 0), (1, 0), (0, 0), (0, 0), (0, 0))
    kw = jnp.concatenate([jnp.pad(kb, pad)[:, :-1], kb], axis=2)
    vw = jnp.concatenate([jnp.pad(vb, pad)[:, :-1], vb], axis=2)
    sc = jnp.einsum("bnqgrd,bnkgd->bngrqk", qb, kw).astype(jnp.float32) * (DH_A ** -0.5)
    i = jnp.arange(BLK)[:, None]
    j = jnp.arange(2 * BLK)[None, :]
    dist = BLK + i - j
    bias = table[:, :HA].T.astype(jnp.float32)[:, rel_bucket(dist)]
    sc = sc + bias.reshape(KV_A, G_A, BLK, 2 * BLK)
    band = (dist >= 0) & (dist < WINDOW)
    blk_ok = (jnp.arange(nb)[:, None] > 0) | (jnp.arange(2 * BLK)[None, :] >= BLK)
    mask = band[None, :, :] & blk_ok[:, None, :]
    sc = jnp.where(mask[None, :, None, None], sc, -jnp.inf)
    sink = sinks.astype(jnp.float32).reshape(KV_A, G_A)[None, None, :, :, None, None]
    m = jnp.maximum(sc.max(-1, keepdims=True), sink)
    p = jnp.exp(sc - m)
    p = p / (p.sum(-1, keepdims=True) + jnp.exp(sink - m))
    o = jnp.einsum("bngrqk,bnkgd->bnqgrd", p.astype(v.dtype), vw)
    return o.reshape(b, s, HA * DH_A)


def diff_attention(q, k, v, lam, lambda_init, subln_w, table):
    b, s = q.shape[0], q.shape[1]
    nb = s // BLK
    qblocks = q.reshape(b, nb, BLK, HB, 2, DH_B).transpose(1, 0, 2, 3, 4, 5)
    kpos = jnp.arange(s)
    tb = table[:, HA:].T.astype(jnp.float32)

    def one_block(args):
        n, qb = args
        sc = jnp.einsum("bqhcd,bkhcd->bchqk", qb, k).astype(jnp.float32) * (DH_B ** -0.5)
        qpos = n * BLK + jnp.arange(BLK)
        dist = qpos[:, None] - kpos[None, :]
        sc = jnp.where(dist >= 0, sc + tb[:, rel_bucket(dist)][None, None], -jnp.inf)
        p = jax.nn.softmax(sc, axis=-1)
        a = p[:, 0] - lam * p[:, 1]
        return jnp.einsum("bhqk,bkhe->bqhe", a.astype(v.dtype), v)

    o = lax.map(one_block, (jnp.arange(nb), qblocks))
    o = o.transpose(1, 0, 2, 3, 4).reshape(b, s, HB, 2 * DH_B).astype(jnp.float32)
    o = o * lax.rsqrt(jnp.square(o).mean(-1, keepdims=True) + LN_EPS) * subln_w.astype(jnp.float32)
    o = o * (1.0 - lambda_init)
    return o.reshape(b, s, HB * 2 * DH_B).astype(v.dtype)


def memory_cross_attention(h, mem, w_cq, w_mem_kv, w_co):
    b, s = h.shape[0], h.shape[1]
    q = (h @ w_cq).reshape(b, s, HC, DH_C)
    kv = (mem @ w_mem_kv).reshape(b, mem.shape[1], 2, HC, DH_C)
    sc = jnp.einsum("bqhd,bkhd->bhqk", q, kv[:, :, 0]).astype(jnp.float32) * (DH_C ** -0.5)
    p = jax.nn.softmax(sc, axis=-1)
    o = jnp.einsum("bhqk,bkhd->bqhd", p.astype(h.dtype), kv[:, :, 1])
    return o.reshape(b, s, HC * DH_C) @ w_co


def swiglu(h, w_gate_up, w_down):
    gu = h @ w_gate_up
    g, u = gu[..., :D_FF], gu[..., D_FF:]
    return (jax.nn.silu(g) * u) @ w_down


def setup_inputs(seed: int = 0) -> dict:
    key = jax.random.key(seed)
    ks = jax.random.split(key, 28)
    beta = (8 * DEPTH) ** -0.25

    def nrm(k, shape, scale):
        return jax.random.normal(k, shape, jnp.float32) * scale

    L = DEPTH
    return {
        "x": nrm(ks[0], (BATCH, SEQ, D_MODEL), 1.0),
        "mem": nrm(ks[1], (BATCH, MEM_LEN, D_MODEL), 1.0),
        "rel_bias_table": nrm(ks[2], (N_BUCKETS, H_BIAS), 0.5),
        "w_in": nrm(ks[3], (L, D_MODEL, IN_WIDTH), D_MODEL ** -0.5),
        "sinks": nrm(ks[4], (L, HA), 0.5),
        "lambda_q1": nrm(ks[5], (L, DH_B), 0.1),
        "lambda_k1": nrm(ks[6], (L, DH_B), 0.1),
        "lambda_q2": nrm(ks[7], (L, DH_B), 0.1),
        "lambda_k2": nrm(ks[8], (L, DH_B), 0.1),
        "subln_w": 1.0 + nrm(ks[9], (L, 2 * DH_B), 0.02),
        "w_branch_a": nrm(ks[10], (L, QA_W, D_MODEL), QA_W ** -0.5),
        "w_branch_b": nrm(ks[11], (L, VB_W, D_MODEL), VB_W ** -0.5),
        "w_o": nrm(ks[12], (L, D_MODEL, D_MODEL), beta * D_MODEL ** -0.5),
        "ln1_g": 1.0 + nrm(ks[13], (L, D_MODEL), 0.02),
        "ln1_b": nrm(ks[14], (L, D_MODEL), 0.02),
        "w_cq": nrm(ks[15], (L, D_MODEL, HC * DH_C), D_MODEL ** -0.5),
        "w_mem_kv": nrm(ks[16], (L, D_MODEL, 2 * HC * DH_C), D_MODEL ** -0.5),
        "w_co": nrm(ks[17], (L, HC * DH_C, D_MODEL), beta * (HC * DH_C) ** -0.5),
        "ln2_g": 1.0 + nrm(ks[18], (L, D_MODEL), 0.02),
        "ln2_b": nrm(ks[19], (L, D_MODEL), 0.02),
        "w_gate_up": nrm(ks[20], (L, D_MODEL, 2 * D_FF), D_MODEL ** -0.5),
        "w_down": nrm(ks[21], (L, D_FF, D_MODEL), beta * D_FF ** -0.5),
        "ln3_g": 1.0 + nrm(ks[22], (L, D_MODEL), 0.02),
        "ln3_b": nrm(ks[23], (L, D_MODEL), 0.02),
    }


def reference(x, mem, rel_bias_table, w_in, sinks, lambda_q1, lambda_k1, lambda_q2, lambda_k2,
              subln_w, w_branch_a, w_branch_b, w_o, ln1_g, ln1_b, w_cq, w_mem_kv, w_co,
              ln2_g, ln2_b, w_gate_up, w_down, ln3_g, ln3_b):
    alpha = (2 * DEPTH) ** 0.25
    b, s = x.shape[0], x.shape[1]
    h = x
    for l in range(DEPTH):
        lambda_init = 0.8 - 0.6 * math.exp(-0.3 * l)
        proj = h @ w_in[l]
        qa, ka, va, qb, kb, vb, ga, gb = jnp.split(proj, SPLIT_IDX, axis=-1)
        o_a = swa_sink_attention(qa.reshape(b, s, HA, DH_A), ka.reshape(b, s, KV_A, DH_A),
                                 va.reshape(b, s, KV_A, DH_A), sinks[l], rel_bias_table)
        f32 = jnp.float32
        lam = (jnp.exp(jnp.sum(lambda_q1[l].astype(f32) * lambda_k1[l].astype(f32)))
               - jnp.exp(jnp.sum(lambda_q2[l].astype(f32) * lambda_k2[l].astype(f32)))
               + lambda_init)
        o_b = diff_attention(qb.reshape(b, s, HB, 2, DH_B), kb.reshape(b, s, HB, 2, DH_B),
                             vb.reshape(b, s, HB, 2 * DH_B), lam, lambda_init, subln_w[l],
                             rel_bias_table)
        mix = jax.nn.sigmoid(ga) * (o_a @ w_branch_a[l]) + jax.nn.sigmoid(gb) * (o_b @ w_branch_b[l])
        h = layer_norm(alpha * h + mix @ w_o[l], ln1_g[l], ln1_b[l])
        c = memory_cross_attention(h, mem, w_cq[l], w_mem_kv[l], w_co[l])
        h = layer_norm(alpha * h + c, ln2_g[l], ln2_b[l])
        f = swiglu(h, w_gate_up[l], w_down[l])
        h = layer_norm(alpha * h + f, ln3_g[l], ln3_b[l])
    return h
```

```cpp
#include <hip/hip_runtime.h>
#include <cstdio>
#include <cstdint>

typedef unsigned short bf16_t;
typedef short bf16x8 __attribute__((ext_vector_type(8)));
typedef float f32x4 __attribute__((ext_vector_type(4)));
typedef float f32x16 __attribute__((ext_vector_type(16)));
typedef unsigned u32x4 __attribute__((ext_vector_type(4)));
typedef unsigned u32x2 __attribute__((ext_vector_type(2)));

constexpr int S = 8192, D = 2048, INW = 8448, MEML = 256, DFF = 5632;
constexpr int HA = 16, HB = 8;
constexpr int C_QA = 0, C_KA = 1024, C_VA = 1152, C_QB = 1280, C_KB = 2304, C_VB = 3328, C_GA = 4352, C_GB = 6400;
constexpr float LOG2E = 1.4426950408889634f;
constexpr float C2 = 0.125f * LOG2E;
constexpr float CC2 = 0.08838834764831845f * LOG2E;
constexpr float ALPHA = 1.189207115002721f;
constexpr float LN_EPS = 1e-5f;
constexpr float LAMBDA_INIT = 0.2f;

__device__ const unsigned char BUCKET[128] = {0, 1, 2, 3, 4, 5, 6, 7, 8, 9, 10, 11, 12, 13, 14, 15, 16, 16, 16, 17, 17, 18, 18, 18, 19, 19, 19, 20, 20, 20, 20, 21, 21, 21, 21, 22, 22, 22, 22, 22, 23, 23, 23, 23, 23, 23, 24, 24, 24, 24, 24, 24, 25, 25, 25, 25, 25, 25, 25, 26, 26, 26, 26, 26, 26, 26, 26, 27, 27, 27, 27, 27, 27, 27, 27, 27, 27, 28, 28, 28, 28, 28, 28, 28, 28, 28, 28, 29, 29, 29, 29, 29, 29, 29, 29, 29, 29, 29, 29, 30, 30, 30, 30, 30, 30, 30, 30, 30, 30, 30, 30, 30, 30, 31, 31, 31, 31, 31, 31, 31, 31, 31, 31, 31, 31, 31, 31, 31};

constexpr size_t MiB = 1u << 20;
constexpr size_t WS_CTL = 0, WS_WINT = 4 * MiB, WS_WABT = 37 * MiB, WS_WOT = 45 * MiB, WS_WCQB = 53 * MiB, WS_WMKVT = 55 * MiB, WS_WCOT = 59 * MiB,
                 WS_WGUT = 61 * MiB, WS_WDT = 105 * MiB, WS_MEMB = 127 * MiB, WS_KVMEM = 128 * MiB, WS_WQKT = 129 * MiB, WS_VWT = 133 * MiB,
                 WS_SA = 137 * MiB, WS_SB = 169 * MiB, WS_BIG = 201 * MiB, WS_END = 333 * MiB;

__device__ __forceinline__ float bf2f(bf16_t v) { return __uint_as_float((unsigned)v << 16); }
__device__ __forceinline__ unsigned f2bf(float f) { unsigned u = __float_as_uint(f); return (u + 0x7fffu + ((u >> 16) & 1u)) >> 16; }
__device__ __forceinline__ unsigned pk2(float lo, float hi) { return f2bf(lo) | (f2bf(hi) << 16); }
__device__ __forceinline__ int crow(int r, int hi) { return (r & 3) + 8 * (r >> 2) + 4 * hi; }
__device__ __forceinline__ float sigmoidf_(float x) { return 1.0f / (1.0f + __expf(-x)); }
__device__ __forceinline__ float wave_sum(float v) {
#pragma unroll
    for (int o = 1; o < 64; o <<= 1) v += __shfl_xor(v, o);
    return v;
}
__device__ __forceinline__ float wave_max(float v) {
#pragma unroll
    for (int o = 1; o < 64; o <<= 1) v = fmaxf(v, __shfl_xor(v, o));
    return v;
}

__global__ void __launch_bounds__(256) k_transpose(const float* __restrict__ W, int K, int N, bf16_t* __restrict__ WT, int mode) {
    __shared__ float scr_all[4][64 * 33];
    const int lane = threadIdx.x & 63, wave = threadIdx.x >> 6;
    float* scr = scr_all[wave];
    const int nblk = N / 32, nitems = (K / 64) * nblk;
    for (int item = blockIdx.x * 4 + wave; item < nitems; item += gridDim.x * 4) {
        const int kb = item / nblk, nb = item % nblk, k0 = 64 * kb, n0 = 32 * nb;
#pragma unroll 8
        for (int i = 0; i < 32; ++i) { const int kk = 2 * i + (lane >> 5); scr[kk * 33 + (lane & 31)] = W[(size_t)(k0 + kk) * N + n0 + (lane & 31)]; }
        asm volatile("s_waitcnt lgkmcnt(0)" ::: "memory");
        int rbase;
        if (mode == 0) rbase = n0;
        else { rbase = (n0 < DFF) ? (n0 / 128) * 256 + (n0 % 128) : ((n0 - DFF) / 128) * 256 + 128 + ((n0 - DFF) % 128); }
        const int c = lane & 7;
#pragma unroll
        for (int j = 0; j < 4; ++j) { const int n = (lane >> 3) + 8 * j; const float* s = scr + (8 * c) * 33 + n;
            u32x4 o; o.x = pk2(s[0 * 33], s[1 * 33]); o.y = pk2(s[2 * 33], s[3 * 33]); o.z = pk2(s[4 * 33], s[5 * 33]); o.w = pk2(s[6 * 33], s[7 * 33]);
            *(u32x4*)(WT + (size_t)(rbase + n) * K + k0 + 8 * c) = o; }
        asm volatile("s_waitcnt lgkmcnt(0)" ::: "memory");
    }
}
__global__ void __launch_bounds__(256) k_cvt(const float* __restrict__ in, bf16_t* __restrict__ out, size_t n4) {
    for (size_t i = (size_t)blockIdx.x * 256 + threadIdx.x; i < n4; i += (size_t)gridDim.x * 256) {
        const f32x4 v = ((const f32x4*)in)[i]; u32x2 o; o.x = pk2(v.x, v.y); o.y = pk2(v.z, v.w); ((u32x2*)out)[i] = o; }
}

template <int OFF, class Epi>
__global__ void __launch_bounds__(256) k_sgemm(const bf16_t* __restrict__ A, int lda, const bf16_t* __restrict__ Bt, int ldb, int K, Epi epi) {
    const int lane = threadIdx.x & 63, wave = threadIdx.x >> 6, r32 = lane & 31, hi = lane >> 5, wrx = wave >> 1, wcx = wave & 1;
    const int cp = blockIdx.x * 2 + wcx;
    const int cb = (OFF == 32) ? 64 * cp : (cp >> 2) * 256 + (cp & 3) * 32;
    const int r0 = blockIdx.y * 128 + wrx * 64;
    const bf16_t* a0 = A + (size_t)(r0 + r32) * lda + 8 * hi; const bf16_t* a1 = a0 + (size_t)32 * lda;
    const bf16_t* b0 = Bt + (size_t)(cb + r32) * ldb + 8 * hi; const bf16_t* b1 = b0 + (size_t)OFF * ldb;
    f32x16 acc[2][2];
#pragma unroll
    for (int i = 0; i < 2; ++i)
#pragma unroll
        for (int j = 0; j < 2; ++j)
#pragma unroll
            for (int r = 0; r < 16; ++r) acc[i][j][r] = 0.f;
    for (int k0 = 0; k0 < K; k0 += 64) {
        bf16x8 fa0[4], fa1[4], fb0[4], fb1[4];
#pragma unroll
        for (int u = 0; u < 4; ++u) { fa0[u] = *(const bf16x8*)(a0 + k0 + 16 * u); fa1[u] = *(const bf16x8*)(a1 + k0 + 16 * u); fb0[u] = *(const bf16x8*)(b0 + k0 + 16 * u); fb1[u] = *(const bf16x8*)(b1 + k0 + 16 * u); }
#pragma unroll
        for (int u = 0; u < 4; ++u) {
            acc[0][0] = __builtin_amdgcn_mfma_f32_32x32x16_bf16(fa0[u], fb0[u], acc[0][0], 0, 0, 0);
            acc[0][1] = __builtin_amdgcn_mfma_f32_32x32x16_bf16(fa0[u], fb1[u], acc[0][1], 0, 0, 0);
            acc[1][0] = __builtin_amdgcn_mfma_f32_32x32x16_bf16(fa1[u], fb0[u], acc[1][0], 0, 0, 0);
            acc[1][1] = __builtin_amdgcn_mfma_f32_32x32x16_bf16(fa1[u], fb1[u], acc[1][1], 0, 0, 0);
        }
    }
#pragma unroll
    for (int i = 0; i < 2; ++i)
#pragma unroll
        for (int r = 0; r < 16; ++r) epi(r0 + 32 * i + crow(r, hi), cb + r32, acc[i][0][r], acc[i][1][r]);
}
struct EStoreBf16 { bf16_t* C; int ldc; float scale;
    __device__ void operator()(int row, int col, float v0, float v1) const { C[(size_t)row * ldc + col] = (bf16_t)f2bf(v0 * scale); C[(size_t)row * ldc + col + 32] = (bf16_t)f2bf(v1 * scale); } };
struct EProj { bf16_t* C;
    __device__ void operator()(int row, int col, float v0, float v1) const {
        const float sc = (col < C_KA || (col >= C_QB && col < C_KB)) ? C2 : 1.0f;
        C[(size_t)row * INW + col] = (bf16_t)f2bf(v0 * sc); C[(size_t)row * INW + col + 32] = (bf16_t)f2bf(v1 * sc); } };
struct EStoreF32 { float* C; int ldc;
    __device__ void operator()(int row, int col, float v0, float v1) const { C[(size_t)row * ldc + col] = v0; C[(size_t)row * ldc + col + 32] = v1; } };
struct EBranch0 { const bf16_t* proj; float* tmp;
    __device__ void operator()(int row, int col, float v0, float v1) const {
        const bf16_t* g = proj + (size_t)row * INW + C_GA + col;
        tmp[(size_t)row * D + col] = sigmoidf_(bf2f(g[0])) * v0; tmp[(size_t)row * D + col + 32] = sigmoidf_(bf2f(g[32])) * v1; } };
struct EBranch1 { const bf16_t* proj; const float* tmp; bf16_t* mix;
    __device__ void operator()(int row, int col, float v0, float v1) const {
        const bf16_t* g = proj + (size_t)row * INW + C_GB + col; const size_t o = (size_t)row * D + col;
        mix[o] = (bf16_t)f2bf(tmp[o] + sigmoidf_(bf2f(g[0])) * v0); mix[o + 32] = (bf16_t)f2bf(tmp[o + 32] + sigmoidf_(bf2f(g[32])) * v1); } };
struct EResid { const float* base; float* out;
    __device__ void operator()(int row, int col, float v0, float v1) const { const size_t o = (size_t)row * D + col;
        const float b0 = base[o], b1 = base[o + 32]; out[o] = ALPHA * b0 + v0; out[o + 32] = ALPHA * b1 + v1; } };
struct ESwiglu { bf16_t* ff;
    __device__ void operator()(int row, int col, float v0, float v1) const {
        const int hcol = (col >> 8) * 128 + (col & 255); const float s = v0 / (1.0f + __expf(-v0));
        ff[(size_t)row * DFF + hcol] = (bf16_t)f2bf(s * v1); } };

__global__ void __launch_bounds__(256) k_attn_a(const bf16_t* __restrict__ proj, const float* __restrict__ table, const float* __restrict__ sinks, bf16_t* __restrict__ oa) {
    const int s = blockIdx.x * 256 + threadIdx.x, h = blockIdx.y, g = h >> 3;
    float q[64], o[64];
    const bf16_t* qp = proj + (size_t)s * INW + C_QA + h * 64;
#pragma unroll
    for (int d = 0; d < 64; ++d) { q[d] = bf2f(qp[d]); o[d] = 0.f; }
    float m = -INFINITY, l = 0.f;
    const int k_lo = s - 127 < 0 ? 0 : s - 127;
    for (int kp = k_lo; kp <= s; ++kp) {
        const bf16_t* kr = proj + (size_t)kp * INW + C_KA + g * 64; const bf16_t* vr = proj + (size_t)kp * INW + C_VA + g * 64;
        float dot = 0.f;
#pragma unroll
        for (int d = 0; d < 64; ++d) dot += q[d] * bf2f(kr[d]);
        const float sc = dot + table[BUCKET[s - kp] * 24 + h] * LOG2E;
        const float mn = fmaxf(m, sc), al = exp2f(m - mn), p = exp2f(sc - mn);
        l = l * al + p;
#pragma unroll
        for (int d = 0; d < 64; ++d) o[d] = o[d] * al + p * bf2f(vr[d]);
        m = mn;
    }
    const float sk = sinks[h] * LOG2E, mf = fmaxf(m, sk), al = exp2f(m - mf), den = l * al + exp2f(sk - mf), sc = al / den;
    bf16_t* op = oa + (size_t)s * 1024 + h * 64;
#pragma unroll
    for (int d = 0; d < 64; ++d) op[d] = (bf16_t)f2bf(o[d] * sc);
}
__global__ void __launch_bounds__(256) k_attn_b(const bf16_t* __restrict__ proj, const float* __restrict__ table, bf16_t* __restrict__ ob) {
    __shared__ float Ks[64][64]; __shared__ float Vs[64][64];
    const int tid = threadIdx.x, s = blockIdx.x * 256 + tid, vhd = blockIdx.y, h = vhd >> 2, c = (vhd >> 1) & 1, vh = vhd & 1;
    float q[64], o[64];
    const bf16_t* qp = proj + (size_t)s * INW + C_QB + h * 128 + c * 64;
#pragma unroll
    for (int d = 0; d < 64; ++d) { q[d] = bf2f(qp[d]); o[d] = 0.f; }
    float m = -INFINITY, l = 0.f;
    const float bfar = table[31 * 24 + HA + h];
    const int NT = 4 * blockIdx.x + 4;
    for (int t = 0; t < NT; ++t) {
        __syncthreads();
        { const int key = tid >> 2, seg = (tid & 3) * 16; const size_t rowo = (size_t)(64 * t + key) * INW;
          const bf16_t* kr = proj + rowo + C_KB + h * 128 + c * 64 + seg; const bf16_t* vr = proj + rowo + C_VB + h * 128 + vh * 64 + seg;
#pragma unroll
          for (int d = 0; d < 16; ++d) { Ks[key][seg + d] = bf2f(kr[d]); Vs[key][seg + d] = bf2f(vr[d]); } }
        __syncthreads();
        for (int j = 0; j < 64; ++j) {
            const int kp = 64 * t + j;
            if (kp <= s) {
                float dot = 0.f;
#pragma unroll
                for (int d = 0; d < 64; ++d) dot += q[d] * Ks[j][d];
                const int dist = s - kp;
                const float bias = dist < 128 ? (table[BUCKET[dist] * 24 + HA + h] - bfar) * LOG2E : 0.f;
                const float sc = dot + bias;
                const float mn = fmaxf(m, sc), al = exp2f(m - mn), p = exp2f(sc - mn);
                l = l * al + p;
#pragma unroll
                for (int d = 0; d < 64; ++d) o[d] = o[d] * al + p * Vs[j][d];
                m = mn;
            }
        }
    }
    const float inv = 1.0f / l;
    bf16_t* op = ob + (size_t)s * 2048 + vhd * 64;
#pragma unroll
    for (int d = 0; d < 64; ++d) op[d] = (bf16_t)f2bf(o[d] * inv);
}
__global__ void __launch_bounds__(256) k_combine(const bf16_t* __restrict__ ob, const float* __restrict__ lq1, const float* __restrict__ lk1, const float* __restrict__ lq2, const float* __restrict__ lk2,
                                                 const float* __restrict__ subw, bf16_t* __restrict__ out) {
    const int lane = threadIdx.x & 63, row = blockIdx.x * 4 + (threadIdx.x >> 6);
    const float lam = __expf(wave_sum(lq1[lane] * lk1[lane])) - __expf(wave_sum(lq2[lane] * lk2[lane])) + LAMBDA_INIT;
    const int h = lane >> 3, sub = lane & 7, vh = sub >> 2, e0 = (sub & 3) * 16;
    const bf16_t* p0 = ob + (size_t)row * 2048 + ((h * 2 + 0) * 2 + vh) * 64 + e0;
    const bf16_t* p1 = ob + (size_t)row * 2048 + ((h * 2 + 1) * 2 + vh) * 64 + e0;
    float v[16]; float ss = 0.f;
#pragma unroll
    for (int i = 0; i < 16; ++i) { v[i] = bf2f(p0[i]) - lam * bf2f(p1[i]); ss += v[i] * v[i]; }
    ss += __shfl_xor(ss, 1); ss += __shfl_xor(ss, 2); ss += __shfl_xor(ss, 4);
    const float r = rsqrtf(ss * (1.0f / 128.0f) + LN_EPS) * (1.0f - LAMBDA_INIT);
    bf16_t* op = out + (size_t)row * 1024 + h * 128 + vh * 64 + e0;
#pragma unroll
    for (int i = 0; i < 16; ++i) op[i] = (bf16_t)f2bf(v[i] * r * subw[vh * 64 + e0 + i]);
}
__global__ void __launch_bounds__(256) k_ln(float* __restrict__ z, const float* __restrict__ g, const float* __restrict__ b, bf16_t* __restrict__ zb) {
    const int lane = threadIdx.x & 63, row = blockIdx.x * 4 + (threadIdx.x >> 6);
    f32x4* zr = (f32x4*)(z + (size_t)row * D) + lane;
    f32x4 v[8]; float s = 0.f;
#pragma unroll
    for (int j = 0; j < 8; ++j) { v[j] = zr[64 * j]; s += (v[j].x + v[j].y) + (v[j].z + v[j].w); }
    const float mean = wave_sum(s) * (1.0f / D); float s2 = 0.f;
#pragma unroll
    for (int j = 0; j < 8; ++j) { v[j] = v[j] - mean; s2 += (v[j].x * v[j].x + v[j].y * v[j].y) + (v[j].z * v[j].z + v[j].w * v[j].w); }
    const float rstd = rsqrtf(wave_sum(s2) * (1.0f / D) + LN_EPS);
#pragma unroll
    for (int j = 0; j < 8; ++j) { const f32x4 gg = ((const f32x4*)g)[lane + 64 * j], bb = ((const f32x4*)b)[lane + 64 * j];
        const f32x4 o = v[j] * rstd * gg + bb; zr[64 * j] = o;
        if (zb) { u32x2 w; w.x = pk2(o.x, o.y); w.y = pk2(o.z, o.w); ((u32x2*)(zb + (size_t)row * D))[lane + 64 * j] = w; } }
}
__global__ void __launch_bounds__(256) k_softmax256(const float* __restrict__ sc, bf16_t* __restrict__ p) {
    const int lane = threadIdx.x & 63, idx = blockIdx.x * 4 + (threadIdx.x >> 6);
    const f32x4 v = ((const f32x4*)(sc + (size_t)idx * 256))[lane];
    const float m = wave_max(fmaxf(fmaxf(v.x, v.y), fmaxf(v.z, v.w)));
    const float e0 = exp2f(v.x - m), e1 = exp2f(v.y - m), e2 = exp2f(v.z - m), e3 = exp2f(v.w - m);
    const float inv = 1.0f / wave_sum((e0 + e1) + (e2 + e3));
    u32x2 w; w.x = pk2(e0 * inv, e1 * inv); w.y = pk2(e2 * inv, e3 * inv); ((u32x2*)(p + (size_t)idx * 256))[lane] = w;
}

template <int OFF, class Epi>
static void sgemm(hipStream_t st, const bf16_t* A, int lda, const bf16_t* Bt, int ldb, int M, int N, int K, Epi e) {
    hipLaunchKernelGGL((k_sgemm<OFF, Epi>), dim3(N / 128, M / 128), dim3(256), 0, st, A, lda, Bt, ldb, K, e);
}

extern "C" void kernel_launch(void* const* d_in, const int* in_sizes, int n_in, void* d_out, int out_size, void* d_ws, size_t ws_size, hipStream_t stream) {
    if (n_in != 24 || in_sizes[0] != S * D || out_size != S * D || ws_size < WS_END) { fprintf(stderr, "kernel_launch: unexpected shapes / workspace (n_in %d, ws %zu)\n", n_in, ws_size); return; }
    const float* x = (const float*)d_in[0]; const float* mem = (const float*)d_in[1]; const float* table = (const float*)d_in[2]; const float* w_in = (const float*)d_in[3];
    const float* sinks = (const float*)d_in[4]; const float* lq1 = (const float*)d_in[5]; const float* lk1 = (const float*)d_in[6]; const float* lq2 = (const float*)d_in[7]; const float* lk2 = (const float*)d_in[8];
    const float* subw = (const float*)d_in[9]; const float* w_a = (const float*)d_in[10]; const float* w_b = (const float*)d_in[11]; const float* w_o = (const float*)d_in[12];
    const float* ln1g = (const float*)d_in[13]; const float* ln1b = (const float*)d_in[14]; const float* w_cq = (const float*)d_in[15]; const float* w_mkv = (const float*)d_in[16]; const float* w_co = (const float*)d_in[17];
    const float* ln2g = (const float*)d_in[18]; const float* ln2b = (const float*)d_in[19]; const float* w_gu = (const float*)d_in[20]; const float* w_dn = (const float*)d_in[21];
    const float* ln3g = (const float*)d_in[22]; const float* ln3b = (const float*)d_in[23];
    unsigned char* ws = (unsigned char*)d_ws; float* out = (float*)d_out;
    bf16_t* WINT = (bf16_t*)(ws + WS_WINT); bf16_t* WABT = (bf16_t*)(ws + WS_WABT); bf16_t* WOT = (bf16_t*)(ws + WS_WOT); bf16_t* WCQB = (bf16_t*)(ws + WS_WCQB);
    bf16_t* WMKVT = (bf16_t*)(ws + WS_WMKVT); bf16_t* WCOT = (bf16_t*)(ws + WS_WCOT); bf16_t* WGUT = (bf16_t*)(ws + WS_WGUT); bf16_t* WDT = (bf16_t*)(ws + WS_WDT);
    bf16_t* MEMB = (bf16_t*)(ws + WS_MEMB); bf16_t* KVMEM = (bf16_t*)(ws + WS_KVMEM); bf16_t* WQKT = (bf16_t*)(ws + WS_WQKT); bf16_t* VWT = (bf16_t*)(ws + WS_VWT);
    bf16_t* XB = (bf16_t*)(ws + WS_SA); bf16_t* OBV = XB; bf16_t* MIX = XB; bf16_t* PC = XB;
    bf16_t* OAB = (bf16_t*)(ws + WS_SB); bf16_t* H1B = OAB; bf16_t* H2B = OAB;
    bf16_t* PROJ = (bf16_t*)(ws + WS_BIG); bf16_t* FF = PROJ; float* SC = (float*)(ws + WS_BIG);
    hipLaunchKernelGGL(k_transpose, dim3(2048), dim3(256), 0, stream, w_in, D, INW, WINT, 0);
    hipLaunchKernelGGL(k_transpose, dim3(1024), dim3(256), 0, stream, w_a, 1024, D, WABT, 0);
    hipLaunchKernelGGL(k_transpose, dim3(1024), dim3(256), 0, stream, w_b, 1024, D, WABT + (size_t)D * 1024, 0);
    hipLaunchKernelGGL(k_transpose, dim3(1024), dim3(256), 0, stream, w_o, D, D, WOT, 0);
    hipLaunchKernelGGL(k_transpose, dim3(1024), dim3(256), 0, stream, w_mkv, D, 1024, WMKVT, 0);
    hipLaunchKernelGGL(k_transpose, dim3(512), dim3(256), 0, stream, w_co, 512, D, WCOT, 0);
    hipLaunchKernelGGL(k_transpose, dim3(2048), dim3(256), 0, stream, w_gu, D, 2 * DFF, WGUT, 1);
    hipLaunchKernelGGL(k_transpose, dim3(2048), dim3(256), 0, stream, w_dn, DFF, D, WDT, 0);
    hipLaunchKernelGGL(k_cvt, dim3(2048), dim3(256), 0, stream, x, XB, (size_t)S * D / 4);
    hipLaunchKernelGGL(k_cvt, dim3(256), dim3(256), 0, stream, mem, MEMB, (size_t)MEML * D / 4);
    hipLaunchKernelGGL(k_cvt, dim3(256), dim3(256), 0, stream, w_cq, WCQB, (size_t)D * 512 / 4);
    sgemm<32>(stream, XB, D, WINT, D, S, INW, D, EProj{PROJ});
    sgemm<32>(stream, MEMB, D, WMKVT, D, MEML, 1024, D, EStoreBf16{KVMEM, 1024, 1.0f});
    for (int h = 0; h < 4; ++h) {
        sgemm<32>(stream, KVMEM + h * 128, 1024, WCQB + h * 128, 512, 256, D, 128, EStoreBf16{WQKT + (size_t)h * 256 * D, D, CC2});
        sgemm<32>(stream, WCOT + h * 128, 512, KVMEM + 512 + h * 128, 1024, D, 256, 128, EStoreBf16{VWT + h * 256, 1024, 1.0f});
    }
    hipLaunchKernelGGL(k_attn_a, dim3(S / 256, HA), dim3(256), 0, stream, PROJ, table, sinks, OAB);
    hipLaunchKernelGGL(k_attn_b, dim3(S / 256, 32), dim3(256), 0, stream, PROJ, table, OBV);
    hipLaunchKernelGGL(k_combine, dim3(S / 4), dim3(256), 0, stream, OBV, lq1, lk1, lq2, lk2, subw, OAB + (size_t)S * 1024);
    sgemm<32>(stream, OAB, 1024, WABT, 1024, S, D, 1024, EBranch0{PROJ, out});
    sgemm<32>(stream, OAB + (size_t)S * 1024, 1024, WABT + (size_t)D * 1024, 1024, S, D, 1024, EBranch1{PROJ, out, MIX});
    sgemm<32>(stream, MIX, D, WOT, D, S, D, D, EResid{x, out});
    hipLaunchKernelGGL(k_ln, dim3(S / 4), dim3(256), 0, stream, out, ln1g, ln1b, H1B);
    sgemm<32>(stream, H1B, D, WQKT, D, S, 1024, D, EStoreF32{SC, 1024});
    hipLaunchKernelGGL(k_softmax256, dim3(S), dim3(256), 0, stream, SC, PC);
    sgemm<32>(stream, PC, 1024, VWT, 1024, S, D, 1024, EResid{out, out});
    hipLaunchKernelGGL(k_ln, dim3(S / 4), dim3(256), 0, stream, out, ln2g, ln2b, H2B);
    sgemm<128>(stream, H2B, D, WGUT, D, S, 2 * DFF, D, ESwiglu{FF});
    sgemm<32>(stream, FF, DFF, WDT, DFF, S, D, DFF, EResid{out, out});
    hipLaunchKernelGGL(k_ln, dim3(S / 4), dim3(256), 0, stream, out, ln3g, ln3b, (bf16_t*)nullptr);
}
```
